# Optimizing an MI355X kernel written in HIP

```python
import math
import jax, jax.numpy as jnp
from jax import lax
import numpy as np

D_MODEL = 1024
BATCH = 32
SEQ = 2048
DEPTH = 1

N_META = 16
BLOCK_Q = 128
SB_HEADS = 8
SB_HEAD_DIM = 64
SB_WIDTH = SB_HEADS * SB_HEAD_DIM
DSA_HEADS = 8
DSA_HEAD_DIM = 64
DSA_WIDTH = DSA_HEADS * DSA_HEAD_DIM
IDX_HEADS = 8
IDX_DIM = 64
TOPK_MAX = 256
REL_BUCKETS = 32
REL_MAX_DIST = 128
LN_EPS = 1e-5
DEEPNORM_ALPHA = (2.0 * DEPTH) ** 0.25
DEEPNORM_BETA = (8.0 * DEPTH) ** -0.25
COLS = [SB_WIDTH, SB_WIDTH, SB_WIDTH, SB_WIDTH,
        DSA_WIDTH, DSA_HEAD_DIM, DSA_HEAD_DIM, DSA_WIDTH,
        IDX_HEADS * IDX_DIM, IDX_DIM, IDX_HEADS,
        D_MODEL, D_MODEL]
IN_COLS = sum(COLS)

kernel_name = "hybrid_stickbreak_dsa_gated"


def layer_norm(x, g, b):
    xf = x.astype(jnp.float32)
    mu = jnp.mean(xf, axis=-1, keepdims=True)
    var = jnp.mean(jnp.square(xf - mu), axis=-1, keepdims=True)
    return ((xf - mu) * lax.rsqrt(var + LN_EPS) * g.astype(jnp.float32) + b.astype(jnp.float32)).astype(x.dtype)


def rel_bucket(dist):
    max_exact = REL_BUCKETS // 2
    nf = jnp.maximum(dist, 1).astype(jnp.float32)
    large = max_exact + (jnp.log(nf / max_exact) / math.log(REL_MAX_DIST / max_exact)
                         * (REL_BUCKETS - max_exact)).astype(jnp.int32)
    large = jnp.minimum(large, REL_BUCKETS - 1)
    return jnp.where(dist < max_exact, dist, large)


def stick_breaking_block(q, k, v, q_pos):
    lk = k.shape[1]
    z = jnp.einsum('bqhd,bkhd->bhqk', q, k).astype(jnp.float32) * (SB_HEAD_DIM ** -0.5)
    mask = jnp.arange(lk)[None, :] < q_pos[:, None]
    log_beta = jax.nn.log_sigmoid(z)
    log_1m = jnp.where(mask, log_beta - z, 0.0)
    suffix = lax.cumsum(log_1m, axis=3, reverse=True) - log_1m
    a = jnp.where(mask, jnp.exp(log_beta + suffix), 0.0)
    return jnp.einsum('bhqk,bkhd->bqhd', a.astype(v.dtype), v)


def dsa_block(q, k, v, qi, ki, wi, q_pos, rel_bias, topk):
    lk = k.shape[1]
    s = jnp.einsum('bqhd,bkd->bqhk', qi, ki).astype(jnp.float32)
    score = jnp.einsum('bqhk,bqh->bqk', jax.nn.relu(s), wi.astype(jnp.float32))
    causal = jnp.arange(lk)[None, :] <= q_pos[:, None]
    score = jnp.where(causal[None], score, -jnp.inf)
    kb = min(topk, lk)
    _, idx = lax.top_k(score, kb)
    gather = jax.vmap(lambda a, i: a[i])
    k_sel = gather(k, idx)
    v_sel = gather(v, idx)
    logits = jnp.einsum('bqhd,bqkd->bqhk', q, k_sel).astype(jnp.float32) * (DSA_HEAD_DIM ** -0.5)
    dist = q_pos[None, :, None] - idx
    valid = dist >= 0
    bias = rel_bias[rel_bucket(jnp.maximum(dist, 0))].astype(jnp.float32)
    logits = logits + jnp.transpose(bias, (0, 1, 3, 2))
    logits = jnp.where(valid[:, :, None, :], logits, -1e30)
    p = jax.nn.softmax(logits, axis=-1)
    return jnp.einsum('bqhk,bqkd->bqhd', p.astype(v_sel.dtype), v_sel)


def hybrid_layer(h, w_in, b_gate, idx_kn_g, idx_kn_b, w_pa, w_pb, w_o, ln_g, ln_b, rel_bias, topk):
    bsz, t_len, _ = h.shape
    proj = h @ w_in
    offs = list(np.cumsum(COLS)[:-1])
    (q_a, k_a, v_a, z_a, q_b, k_b, v_b, z_b, qi, ki, wi, ga, gb) = jnp.split(proj, offs, axis=-1)
    q_a = q_a.reshape(bsz, t_len, SB_HEADS, SB_HEAD_DIM)
    k_a = k_a.reshape(bsz, t_len, SB_HEADS, SB_HEAD_DIM)
    v_a = v_a.reshape(bsz, t_len, SB_HEADS, SB_HEAD_DIM)
    q_b = q_b.reshape(bsz, t_len, DSA_HEADS, DSA_HEAD_DIM)
    qi = qi.reshape(bsz, t_len, IDX_HEADS, IDX_DIM)
    ki = layer_norm(ki, idx_kn_g, idx_kn_b)
    wi = wi * (IDX_HEADS ** -0.5 * IDX_DIM ** -0.5)
    gates = jax.nn.sigmoid(jnp.concatenate([ga, gb], axis=-1) + b_gate)
    g_a, g_b = gates[..., :D_MODEL], gates[..., D_MODEL:]

    pos = jnp.arange(t_len, dtype=jnp.int32)
    n_real = t_len - N_META
    bounds = [(0, N_META)] + [(N_META + i * BLOCK_Q, min(N_META + (i + 1) * BLOCK_Q, t_len))
                              for i in range((n_real + BLOCK_Q - 1) // BLOCK_Q)]
    outs_a, outs_b = [], []
    for (s0, e0) in bounds:
        qp = pos[s0:e0]
        outs_a.append(stick_breaking_block(q_a[:, s0:e0], k_a[:, :e0], v_a[:, :e0], qp))
        outs_b.append(dsa_block(q_b[:, s0:e0], k_b[:, :e0], v_b[:, :e0], qi[:, s0:e0],
                                ki[:, :e0], wi[:, s0:e0], qp, rel_bias, topk))
    y_a = jnp.concatenate(outs_a, axis=1).reshape(bsz, t_len, SB_WIDTH) * jax.nn.silu(z_a)
    y_b = jnp.concatenate(outs_b, axis=1).reshape(bsz, t_len, DSA_WIDTH) * jax.nn.silu(z_b)
    merged = g_a * (y_a @ w_pa) + g_b * (y_b @ w_pb)
    out = merged @ w_o
    return layer_norm(DEEPNORM_ALPHA * h + out, ln_g, ln_b)


def setup_inputs(seed: int = 0) -> dict:
    key = jax.random.key(seed)
    ks = jax.random.split(key, 16)
    f32 = jnp.float32
    n = lambda k, shape, s: (jax.random.normal(k, shape, f32) * s).astype(f32)
    return {
        "x": n(ks[0], (BATCH, SEQ, D_MODEL), 1.0),
        "meta_tokens": n(ks[1], (N_META, D_MODEL), 1.0),
        "ln_in_g": 1.0 + n(ks[2], (D_MODEL,), 0.02),
        "ln_in_b": n(ks[3], (D_MODEL,), 0.02),
        "rel_bias": n(ks[4], (REL_BUCKETS, DSA_HEADS), 0.5),
        "w_in": n(ks[5], (DEPTH, D_MODEL, IN_COLS), D_MODEL ** -0.5),
        "b_gate": n(ks[6], (DEPTH, 2 * D_MODEL), 0.02),
        "idx_kn_g": 1.0 + n(ks[7], (DEPTH, IDX_DIM), 0.02),
        "idx_kn_b": n(ks[8], (DEPTH, IDX_DIM), 0.02),
        "w_pa": n(ks[9], (DEPTH, SB_WIDTH, D_MODEL), SB_WIDTH ** -0.5 * DEEPNORM_BETA),
        "w_pb": n(ks[10], (DEPTH, DSA_WIDTH, D_MODEL), DSA_WIDTH ** -0.5 * DEEPNORM_BETA),
        "w_o": n(ks[11], (DEPTH, D_MODEL, D_MODEL), D_MODEL ** -0.5 * DEEPNORM_BETA),
        "ln_g": 1.0 + n(ks[12], (DEPTH, D_MODEL), 0.02),
        "ln_b": n(ks[13], (DEPTH, D_MODEL), 0.02),
    }


def reference(x, meta_tokens, ln_in_g, ln_in_b, rel_bias, w_in, b_gate, idx_kn_g, idx_kn_b,
              w_pa, w_pb, w_o, ln_g, ln_b):
    bsz, seq, d = x.shape
    topk = min(TOPK_MAX, seq // 4)
    meta = jnp.broadcast_to(meta_tokens[None].astype(x.dtype), (bsz, N_META, d))
    h = layer_norm(jnp.concatenate([meta, x], axis=1), ln_in_g, ln_in_b)
    for l in range(DEPTH):
        h = hybrid_layer(h, w_in[l], b_gate[l], idx_kn_g[l], idx_kn_b[l], w_pa[l], w_pb[l],
                         w_o[l], ln_g[l], ln_b[l], rel_bias, topk)
    return h[:, N_META:]
```

```cpp
#include <hip/hip_runtime.h>
#include <hip/hip_cooperative_groups.h>
#include <cstdio>
#include <cstdint>
namespace cg = cooperative_groups;

#define LAS __attribute__((address_space(3)))
typedef _Float16 f16;
typedef _Float16 h8 __attribute__((ext_vector_type(8)));
typedef _Float16 h4 __attribute__((ext_vector_type(4)));
typedef _Float16 h2 __attribute__((ext_vector_type(2)));
typedef float f32x2 __attribute__((ext_vector_type(2)));
typedef float f32x4 __attribute__((ext_vector_type(4)));
typedef float f32x16 __attribute__((ext_vector_type(16)));
typedef unsigned u32x2 __attribute__((ext_vector_type(2)));
typedef unsigned u32x4 __attribute__((ext_vector_type(4)));
typedef short v4i16_t __attribute__((ext_vector_type(4)));

constexpr int D = 1024, BATCH = 32, SEQ = 2048, NMETA = 16, TT = SEQ + NMETA;
constexpr int MQ = BATCH * SEQ;
constexpr int MK = BATCH * TT;
constexpr int INC = 5832;
constexpr int N1 = 2816, N2 = 3072;
constexpr float LN_EPS = 1e-5f;
constexpr float ALPHA = 1.189207115002721f;
constexpr float LOG2E = 1.4426950408889634f;
constexpr float C2 = 0.125f * LOG2E;
constexpr float WISCALE = 0.04419417382415922f;

constexpr size_t MiB = 1u << 20;
constexpr size_t WS_W1T = 2 * MiB, WS_W2T = 8 * MiB, WS_WPA = 14 * MiB, WS_WPB = 15 * MiB, WS_WO = 16 * MiB;
constexpr size_t WS_H16 = 32 * MiB, WS_OA = 160 * MiB, WS_OB = 224 * MiB;
constexpr size_t WS_QA = 288 * MiB, WS_QB = 352 * MiB, WS_QI = 416 * MiB, WS_KA = 480 * MiB, WS_VA = 548 * MiB;
constexpr size_t WS_KB = 616 * MiB, WS_VB = 625 * MiB, WS_KI = 634 * MiB, WS_WI = 643 * MiB;
constexpr size_t WS_YA = 288 * MiB, WS_YB = 352 * MiB, WS_G = 416 * MiB, WS_T = 672 * MiB, WS_MG = 800 * MiB, WS_END = 928 * MiB;

constexpr int LDS_BYTES = 147456;
constexpr int SPITCH = 2084;
constexpr int S_BYTES = 16 * SPITCH * 4;
constexpr int MASK_OFF = S_BYTES, MASK_W = 66;
constexpr int BTAB_OFF = MASK_OFF + 16 * MASK_W * 4;
constexpr int MERGE_OFF = 32768;
static_assert(BTAB_OFF + 4096 <= LDS_BYTES, "lds");

__device__ const unsigned char BUCKET[128] = {0, 1, 2, 3, 4, 5, 6, 7, 8, 9, 10, 11, 12, 13, 14, 15, 16, 16, 16, 17, 17, 18, 18, 18, 19, 19, 19, 20, 20, 20, 20, 21, 21, 21, 21, 22, 22, 22, 22, 22, 23, 23, 23, 23, 23, 23, 24, 24, 24, 24, 24, 24, 25, 25, 25, 25, 25, 25, 25, 26, 26, 26, 26, 26, 26, 26, 26, 27, 27, 27, 27, 27, 27, 27, 27, 27, 27, 28, 28, 28, 28, 28, 28, 28, 28, 28, 28, 29, 29, 29, 29, 29, 29, 29, 29, 29, 29, 29, 29, 30, 30, 30, 30, 30, 30, 30, 30, 30, 30, 30, 30, 30, 30, 31, 31, 31, 31, 31, 31, 31, 31, 31, 31, 31, 31, 31, 31, 31};

__device__ __forceinline__ unsigned pk_h2(float lo, float hi) { f32x2 v = {lo, hi}; h2 h = __builtin_convertvector(v, h2); return __builtin_bit_cast(unsigned, h); }
__device__ __forceinline__ float wave_sum(float v) {
#pragma unroll
    for (int o = 1; o < 64; o <<= 1) v += __shfl_xor(v, o);
    return v;
}
__device__ __forceinline__ float fsigmoid(float x) { return __builtin_amdgcn_rcpf(1.0f + __builtin_amdgcn_exp2f(-x * LOG2E)); }
__device__ __forceinline__ int opaque_tid() { int t = threadIdx.x; asm volatile("" : "+v"(t)); return t; }
__device__ __forceinline__ unsigned char* opaque_ptr(unsigned char* p) { asm volatile("" : "+s"(p)); return p; }
__device__ __forceinline__ int crow(int r, int hi) { return (r & 3) + 8 * (r >> 2) + 4 * hi; }

namespace pg8 {
constexpr int BM = 256, BK = 64, HALF = 128, HTB = HALF * BK * 2, STAGE_BYTES = 8 * HTB, NXCD = 8, WGM = 8;
__host__ __device__ __forceinline__ int lds_byte(int r, int c) { const int st = (r >> 4) * 2 + (c >> 5), rr = r & 15, cc = c & 31, ob = rr * 64 + cc * 2; return st * 1024 + (ob ^ (((ob >> 9) & 1) << 5)); }
__host__ __device__ __forceinline__ void stage_rc(int b, int& R, int& C) { const int st = b / 1024, sb = b % 1024, swz = sb ^ (((sb >> 9) & 1) << 5); R = (st >> 1) * 16 + swz / 64; C = (st & 1) * 32 + (swz % 64) / 2; }
__host__ __device__ __forceinline__ int perm32(int rho) { const int n = rho >> 4, i = rho & 15; return 8 * (i >> 2) + 4 * n + (i & 3); }
struct Unit { int pm, pn; };
struct Gemm { const f16* A; const f16* Bt; int M, N, K; };
struct StaticOrder {
    int nM, nN, nwg, G, c;
    __device__ void init(int M, int N, int G_, int c_) { nM = M / BM; nN = N / BM; nwg = nM * nN; G = G_; c = c_; }
    __device__ bool next(int i, Unit& u) const {
        const long L = (long)i * G + c; if (L >= nwg) return false;
        int wgid = (int)L; { const int q = nwg / NXCD, r = nwg % NXCD, xcd = wgid % NXCD, off = wgid / NXCD; wgid = (xcd < r ? xcd * (q + 1) : r * (q + 1) + (xcd - r) * q) + off; }
        const int nig = WGM * nN, gid = wgid / nig, fm = gid * WGM, gsz = (nM - fm) < WGM ? (nM - fm) : WGM;
        u.pm = fm + ((wgid % nig) % gsz); u.pn = (wgid % nig) / gsz; return true;
    }
};
struct PanelOrder {
    int nM, nN, G, c;
    __device__ void init(int M, int N, int G_, int c_) { nM = M / BM; nN = N / BM; G = G_; c = c_; }
    __device__ bool next(int i, Unit& u) const { const int p = (i / nN) * G + c; if (p >= nM) return false; u.pm = p; u.pn = i % nN; return true; }
};

template <class Epi, class Sched, bool ALIGN_EPI, bool SP2>
__device__ __forceinline__ void gemm_phase(LAS unsigned char* lds, const Gemm g, const Sched& S, const Epi& E) {
    const int tid = opaque_tid(), wid = __builtin_amdgcn_readfirstlane(tid >> 6), lane = tid & 63, wr = wid >> 2, wc = wid & 3, fr = lane & 15, fq = lane >> 4;
    const int K = g.K, nt = K / BK;
    unsigned voffA[2], voffB[2];
#pragma unroll
    for (int i = 0; i < 2; ++i) { int R, C; stage_rc(tid * 16 + i * 8192, R, C); const int Rb = Epi::PERM ? ((R & ~31) + perm32(R & 31)) : R;
        voffA[i] = (unsigned)(R * K + C) * 2u; voffB[i] = (unsigned)(Rb * K + C) * 2u; }
    const size_t kstep = (size_t)(BK * 2);
    const size_t hstep = (size_t)HALF * K * 2;
    const size_t tstep = 2 * hstep;
    const unsigned ldsw = (unsigned)wid * 1024u;
    const int aoff = lds_byte(wr * 64 + fr, fq * 8), boff = lds_byte(wc * 32 + fr, fq * 8);
#define PG8_SA(b, h) (((b) * 2 + (h)) * HTB)
#define PG8_SB(b, h) ((4 + (b) * 2 + (h)) * HTB)
#define PG8_STAGE(bufoff, gbase, voff) do { _Pragma("unroll") for (int _i = 0; _i < 2; ++_i) \
        __builtin_amdgcn_global_load_lds((const unsigned*)((const char*)(gbase) + (voff)[_i]), (LAS unsigned*)(lds + (bufoff) + ldsw + _i * 8192), 16, 0, 0); } while (0)
#define PG8_LDA(dst, b, h) do { _Pragma("unroll") for (int m = 0; m < 4; ++m) _Pragma("unroll") for (int k = 0; k < 2; ++k) dst[m][k] = *(const LAS h8*)(lds + PG8_SA(b, h) + aoff + m * 2048 + k * 1024); } while (0)
#define PG8_LDB(dst, b, h) do { _Pragma("unroll") for (int n = 0; n < 2; ++n) _Pragma("unroll") for (int k = 0; k < 2; ++k) dst[n][k] = *(const LAS h8*)(lds + PG8_SB(b, h) + boff + n * 2048 + k * 1024); } while (0)
#define PG8_MMA(ai, bj, At, Bt) do { __builtin_amdgcn_s_setprio(1); _Pragma("unroll") for (int m = 0; m < 4; ++m) _Pragma("unroll") for (int n = 0; n < 2; ++n) _Pragma("unroll") for (int k = 0; k < 2; ++k) \
        acc[ai][bj][m][n] = __builtin_amdgcn_mfma_f32_16x16x32_f16(Bt[n][k], At[m][k], acc[ai][bj][m][n], 0, 0, 0); __builtin_amdgcn_s_setprio(0); } while (0)
#define PG8_WAIT_V(n) asm volatile("s_waitcnt vmcnt(" #n ")" ::: "memory")
#define PG8_WAIT_L(n) asm volatile("s_waitcnt lgkmcnt(" #n ")" ::: "memory")
#define PG8_BAR __builtin_amdgcn_s_barrier()
#define PG8_SCHED __builtin_amdgcn_sched_barrier(0)
    Unit cur, nxt; int ui = 0;
    if (!S.next(0, cur)) return;
    f32x4 acc[2][2][4][2];
#pragma unroll
    for (int a = 0; a < 2; ++a)
#pragma unroll
        for (int b = 0; b < 2; ++b)
#pragma unroll
            for (int m = 0; m < 4; ++m)
#pragma unroll
                for (int n = 0; n < 2; ++n) acc[a][b][m][n] = (f32x4){0.f, 0.f, 0.f, 0.f};
    h8 At[4][2], B0[2][2], B1[2][2];
    const char* cA = (const char*)g.A + (size_t)cur.pm * tstep; const char* cB = (const char*)g.Bt + (size_t)cur.pn * tstep;
    if constexpr (SP2) {
        PG8_STAGE(PG8_SB(0, 0), cB, voffB); PG8_STAGE(PG8_SB(0, 1), cB + hstep, voffB); PG8_STAGE(PG8_SA(0, 0), cA, voffA); PG8_STAGE(PG8_SA(0, 1), cA + hstep, voffA);
        if (wr == 1) PG8_BAR;
        PG8_WAIT_V(2); PG8_BAR;
        PG8_STAGE(PG8_SB(1, 0), cB + kstep, voffB); PG8_STAGE(PG8_SA(1, 0), cA + kstep, voffA); PG8_STAGE(PG8_SB(1, 1), cB + hstep + kstep, voffB);
        PG8_WAIT_V(6); PG8_BAR;
    } else {
        PG8_STAGE(PG8_SB(0, 0), cB, voffB); PG8_STAGE(PG8_SA(0, 0), cA, voffA); PG8_STAGE(PG8_SB(0, 1), cB + hstep, voffB); PG8_STAGE(PG8_SA(0, 1), cA + hstep, voffA);
        if (wr == 1) PG8_BAR;
        PG8_WAIT_V(4); PG8_BAR;
        PG8_STAGE(PG8_SB(1, 0), cB + kstep, voffB); PG8_STAGE(PG8_SA(1, 0), cA + kstep, voffA); PG8_STAGE(PG8_SB(1, 1), cB + hstep + kstep, voffB);
        PG8_WAIT_V(6); PG8_BAR;
    }
    for (;;) {
        const bool has_next = S.next(ui + 1, nxt);
        const char* nA = has_next ? (const char*)g.A + (size_t)nxt.pm * tstep : cA; const char* nB = has_next ? (const char*)g.Bt + (size_t)nxt.pn * tstep : cB;
        for (int t = 0; t < nt; t += 2) {
            const bool last = (t == nt - 2);
            const char* a1 = cA + (size_t)(t + 1) * kstep;
            const char* a2 = last ? nA : cA + (size_t)(t + 2) * kstep; const char* b2 = last ? nB : cB + (size_t)(t + 2) * kstep;
            const char* a3 = a2 + kstep; const char* b3 = b2 + kstep;
            if constexpr (SP2) {
            PG8_LDB(B0, 0, 0); PG8_LDB(B1, 0, 1); PG8_SCHED; PG8_LDA(At, 0, 0); PG8_STAGE(PG8_SA(1, 1), a1 + hstep, voffA);
            PG8_WAIT_V(8); PG8_WAIT_L(0); PG8_BAR; PG8_MMA(0, 0, At, B0); PG8_MMA(0, 1, At, B1); PG8_BAR; PG8_SCHED;
            PG8_LDA(At, 0, 1); PG8_STAGE(PG8_SB(0, 0), b2, voffB); PG8_STAGE(PG8_SB(0, 1), b2 + hstep, voffB); PG8_STAGE(PG8_SA(0, 0), a2, voffA);
            PG8_WAIT_V(8); PG8_WAIT_L(0); PG8_BAR; PG8_MMA(1, 0, At, B0); PG8_MMA(1, 1, At, B1); PG8_BAR; PG8_SCHED;
            PG8_LDB(B0, 1, 0); PG8_LDB(B1, 1, 1); PG8_SCHED; PG8_LDA(At, 1, 0); PG8_STAGE(PG8_SA(0, 1), a2 + hstep, voffA);
            PG8_WAIT_V(8); PG8_WAIT_L(0); PG8_BAR; PG8_MMA(0, 0, At, B0); PG8_MMA(0, 1, At, B1); PG8_BAR; PG8_SCHED;
            PG8_LDA(At, 1, 1); PG8_STAGE(PG8_SB(1, 0), b3, voffB); PG8_STAGE(PG8_SB(1, 1), b3 + hstep, voffB); PG8_STAGE(PG8_SA(1, 0), a3, voffA);
            PG8_WAIT_V(8); PG8_WAIT_L(0); PG8_BAR; PG8_MMA(1, 0, At, B0); PG8_MMA(1, 1, At, B1); PG8_BAR; PG8_SCHED;
            } else {
            PG8_LDB(B0, 0, 0); PG8_SCHED; PG8_LDA(At, 0, 0); PG8_STAGE(PG8_SA(1, 1), a1 + hstep, voffA);
            PG8_WAIT_L(8); PG8_BAR; PG8_WAIT_L(0); PG8_MMA(0, 0, At, B0); PG8_BAR; PG8_SCHED;
            PG8_LDB(B1, 0, 1); PG8_STAGE(PG8_SB(0, 0), b2, voffB);
            PG8_BAR; PG8_WAIT_L(0); PG8_MMA(0, 1, At, B1); PG8_BAR;
            PG8_LDA(At, 0, 1); PG8_STAGE(PG8_SA(0, 0), a2, voffA);
            PG8_BAR; PG8_WAIT_L(0); PG8_MMA(1, 0, At, B0); PG8_BAR; PG8_SCHED;
            PG8_STAGE(PG8_SB(0, 1), b2 + hstep, voffB);
            PG8_WAIT_V(6); PG8_BAR; PG8_MMA(1, 1, At, B1); PG8_BAR;
            PG8_LDB(B0, 1, 0); PG8_SCHED; PG8_LDA(At, 1, 0); PG8_STAGE(PG8_SA(0, 1), a2 + hstep, voffA);
            PG8_WAIT_L(8); PG8_BAR; PG8_WAIT_L(0); PG8_MMA(0, 0, At, B0); PG8_BAR; PG8_SCHED;
            PG8_LDB(B1, 1, 1); PG8_STAGE(PG8_SB(1, 0), b3, voffB);
            PG8_BAR; PG8_WAIT_L(0); PG8_MMA(0, 1, At, B1); PG8_BAR;
            PG8_LDA(At, 1, 1); PG8_STAGE(PG8_SA(1, 0), a3, voffA);
            PG8_BAR; PG8_WAIT_L(0); PG8_MMA(1, 0, At, B0); PG8_BAR; PG8_SCHED;
            PG8_STAGE(PG8_SB(1, 1), b3 + hstep, voffB);
            PG8_WAIT_V(6); PG8_BAR; PG8_MMA(1, 1, At, B1); PG8_BAR;
            }
        }
        if constexpr (ALIGN_EPI) { if (wr == 0) PG8_BAR; }
        E(acc, cur, wr, wc, fr, fq);
        if (!has_next) break;
#pragma unroll
        for (int a = 0; a < 2; ++a)
#pragma unroll
            for (int b = 0; b < 2; ++b)
#pragma unroll
                for (int m = 0; m < 4; ++m)
#pragma unroll
                    for (int n = 0; n < 2; ++n) acc[a][b][m][n] = (f32x4){0.f, 0.f, 0.f, 0.f};
        cur = nxt; cA = nA; cB = nB; ++ui;
        if constexpr (ALIGN_EPI) { if (wr == 1) PG8_BAR; }
    }
    PG8_WAIT_V(0);
    if constexpr (!ALIGN_EPI) { if (wr == 0) PG8_BAR; }
    PG8_BAR;
#undef PG8_SA
#undef PG8_SB
#undef PG8_STAGE
#undef PG8_LDA
#undef PG8_LDB
#undef PG8_MMA
#undef PG8_WAIT_V
#undef PG8_WAIT_L
#undef PG8_BAR
#undef PG8_SCHED
}
}

__device__ __forceinline__ u32x4 pack8(f32x4 v0, f32x4 v1) { u32x4 w; w.x = pk_h2(v0[0], v0[1]); w.y = pk_h2(v0[2], v0[3]); w.z = pk_h2(v1[0], v1[1]); w.w = pk_h2(v1[2], v1[3]); return w; }

struct EpiA {
    static constexpr bool PERM = true;
    f16 *QA, *QB, *QI, *KA, *VA, *KB, *VB, *KI; float* WI; const float* kn_g; const float* kn_b;
    __device__ __forceinline__ void operator()(const f32x4 (&acc)[2][2][4][2], const pg8::Unit& u, int wr, int wc, int fr, int fq) const {
        const int pn = u.pn, rl0 = wr * 64 + fr;
        const size_t mrow0 = (size_t)u.pm * 256;
        const size_t srow0 = (size_t)(u.pm >> 3) * TT + NMETA + (size_t)(u.pm & 7) * 256;
        if (pn < 10) {
            f16* base; size_t rb; float sc = 1.f;
            const int sel = pn >> 1;
            if (sel == 0) { base = QA; rb = mrow0; sc = C2; }
            else if (sel == 1) { base = KA; rb = srow0; }
            else if (sel == 2) { base = VA; rb = srow0; }
            else if (sel == 3) { base = QB; rb = mrow0; sc = C2; }
            else { base = QI; rb = mrow0; }
            const int col0 = (pn & 1) * 256 + wc * 32 + 8 * fq;
#pragma unroll
            for (int ai = 0; ai < 2; ++ai)
#pragma unroll
                for (int m = 0; m < 4; ++m) { f16* rowp = base + (rb + rl0 + ai * 128 + m * 16) * 512 + col0;
#pragma unroll
                    for (int bj = 0; bj < 2; ++bj) *(u32x4*)(rowp + bj * 128) = pack8(acc[ai][bj][m][0] * sc, acc[ai][bj][m][1] * sc); }
        } else if (wc < 2) {
            f16* base = wc == 0 ? KB : VB;
#pragma unroll
            for (int ai = 0; ai < 2; ++ai)
#pragma unroll
                for (int m = 0; m < 4; ++m) { f16* rowp = base + (srow0 + rl0 + ai * 128 + m * 16) * 64 + 8 * fq;
#pragma unroll
                    for (int bj = 0; bj < 2; ++bj) *(u32x4*)(rowp + bj * 32) = pack8(acc[ai][bj][m][0], acc[ai][bj][m][1]); }
        } else if (wc == 2) {
            f32x4 gv[2][2], bv[2][2];
#pragma unroll
            for (int bj = 0; bj < 2; ++bj)
#pragma unroll
                for (int n = 0; n < 2; ++n) { gv[bj][n] = *(const f32x4*)(kn_g + 32 * bj + 8 * fq + 4 * n); bv[bj][n] = *(const f32x4*)(kn_b + 32 * bj + 8 * fq + 4 * n); }
#pragma unroll
            for (int ai = 0; ai < 2; ++ai)
#pragma unroll
                for (int m = 0; m < 4; ++m) {
                    float s = 0.f;
#pragma unroll
                    for (int bj = 0; bj < 2; ++bj)
#pragma unroll
                        for (int n = 0; n < 2; ++n) { const f32x4 x = acc[ai][bj][m][n]; s += (x[0] + x[1]) + (x[2] + x[3]); }
                    s += __shfl_xor(s, 16); s += __shfl_xor(s, 32);
                    const float mean = s * (1.f / 64.f); float q = 0.f;
#pragma unroll
                    for (int bj = 0; bj < 2; ++bj)
#pragma unroll
                        for (int n = 0; n < 2; ++n) { const f32x4 d = acc[ai][bj][m][n] - mean; q += (d[0] * d[0] + d[1] * d[1]) + (d[2] * d[2] + d[3] * d[3]); }
                    q += __shfl_xor(q, 16); q += __shfl_xor(q, 32);
                    const float rstd = 1.0f / sqrtf(q * (1.f / 64.f) + LN_EPS);
                    f16* rowp = KI + (srow0 + rl0 + ai * 128 + m * 16) * 64 + 8 * fq;
#pragma unroll
                    for (int bj = 0; bj < 2; ++bj) { const f32x4 o0 = (acc[ai][bj][m][0] - mean) * rstd * gv[bj][0] + bv[bj][0], o1 = (acc[ai][bj][m][1] - mean) * rstd * gv[bj][1] + bv[bj][1];
                        *(u32x4*)(rowp + bj * 32) = pack8(o0, o1); }
                }
        } else {
            if (fq == 0) {
#pragma unroll
                for (int ai = 0; ai < 2; ++ai)
#pragma unroll
                    for (int m = 0; m < 4; ++m) { float* rowp = WI + (mrow0 + rl0 + ai * 128 + m * 16) * 8;
                        *(f32x4*)(rowp) = acc[ai][0][m][0] * WISCALE; *(f32x4*)(rowp + 4) = acc[ai][0][m][1] * WISCALE; }
            }
        }
    }
};

struct EpiZ {
    static constexpr bool PERM = true;
    const f16 *OA, *OB; f16 *YA, *YB, *G; const float* b_gate;
    __device__ __forceinline__ void operator()(const f32x4 (&acc)[2][2][4][2], const pg8::Unit& u, int wr, int wc, int fr, int fq) const {
        const int pn = u.pn; const size_t row0 = (size_t)u.pm * 256 + wr * 64 + fr;
        if (pn < 4) {
            const f16* O = pn < 2 ? OA : OB; f16* Y = pn < 2 ? YA : YB;
            const int col0 = (pn & 1) * 256 + wc * 32 + 8 * fq;
#pragma unroll
            for (int ai = 0; ai < 2; ++ai)
#pragma unroll
                for (int m = 0; m < 4; ++m) { const size_t off = (row0 + ai * 128 + m * 16) * 512 + col0;
#pragma unroll
                    for (int bj = 0; bj < 2; ++bj) { const h8 o = *(const h8*)(O + off + bj * 128); f32x4 y0, y1;
#pragma unroll
                        for (int j = 0; j < 4; ++j) { const float z0 = acc[ai][bj][m][0][j], z1 = acc[ai][bj][m][1][j]; y0[j] = (float)o[j] * z0 * fsigmoid(z0); y1[j] = (float)o[4 + j] * z1 * fsigmoid(z1); }
                        *(u32x4*)(Y + off + bj * 128) = pack8(y0, y1); } }
        } else {
            const int gc0 = (pn - 4) * 256 + wc * 32 + 8 * fq;
#pragma unroll
            for (int bj = 0; bj < 2; ++bj) { const f32x4 b0 = *(const f32x4*)(b_gate + gc0 + bj * 128), b1 = *(const f32x4*)(b_gate + gc0 + bj * 128 + 4);
#pragma unroll
                for (int ai = 0; ai < 2; ++ai)
#pragma unroll
                    for (int m = 0; m < 4; ++m) { f32x4 g0, g1;
#pragma unroll
                        for (int j = 0; j < 4; ++j) { g0[j] = fsigmoid(acc[ai][bj][m][0][j] + b0[j]); g1[j] = fsigmoid(acc[ai][bj][m][1][j] + b1[j]); }
                        *(u32x4*)(G + (row0 + ai * 128 + m * 16) * 2048 + gc0 + bj * 128) = pack8(g0, g1); } }
        }
    }
};

template <int SECOND> struct EpiU {
    static constexpr bool PERM = true;
    const f16* G; f16* T; f16* MG;
    __device__ __forceinline__ void operator()(const f32x4 (&acc)[2][2][4][2], const pg8::Unit& u, int wr, int wc, int fr, int fq) const {
        const size_t row0 = (size_t)u.pm * 256 + wr * 64 + fr; const int col0 = u.pn * 256 + wc * 32 + 8 * fq;
#pragma unroll
        for (int ai = 0; ai < 2; ++ai)
#pragma unroll
            for (int m = 0; m < 4; ++m) { const size_t row = row0 + ai * 128 + m * 16;
#pragma unroll
                for (int bj = 0; bj < 2; ++bj) { const int c = col0 + bj * 128;
                    const h8 g = *(const h8*)(G + row * 2048 + SECOND * 1024 + c); f32x4 v0, v1;
                    if (SECOND) { const h8 t = *(const h8*)(T + row * 1024 + c);
#pragma unroll
                        for (int j = 0; j < 4; ++j) { v0[j] = (float)t[j] + (float)g[j] * acc[ai][bj][m][0][j]; v1[j] = (float)t[4 + j] + (float)g[4 + j] * acc[ai][bj][m][1][j]; }
                        *(u32x4*)(MG + row * 1024 + c) = pack8(v0, v1);
                    } else {
#pragma unroll
                        for (int j = 0; j < 4; ++j) { v0[j] = (float)g[j] * acc[ai][bj][m][0][j]; v1[j] = (float)g[4 + j] * acc[ai][bj][m][1][j]; }
                        *(u32x4*)(T + row * 1024 + c) = pack8(v0, v1); } } }
    }
};

struct EpiR {
    static constexpr bool PERM = false;
    const f16* H; float* out;
    __device__ __forceinline__ void operator()(const f32x4 (&acc)[2][2][4][2], const pg8::Unit& u, int wr, int wc, int fr, int fq) const {
        const size_t row0 = (size_t)u.pm * 256 + wr * 64 + fr; const int col0 = u.pn * 256 + wc * 32 + 4 * fq;
#pragma unroll
        for (int ai = 0; ai < 2; ++ai)
#pragma unroll
            for (int m = 0; m < 4; ++m) { const size_t off = (row0 + ai * 128 + m * 16) * D + col0;
#pragma unroll
                for (int bj = 0; bj < 2; ++bj)
#pragma unroll
                    for (int n = 0; n < 2; ++n) { const h4 h = *(const h4*)(H + off + bj * 128 + n * 16); f32x4 o;
#pragma unroll
                        for (int j = 0; j < 4; ++j) o[j] = ALPHA * (float)h[j] + acc[ai][bj][m][n][j];
                        *(f32x4*)(out + off + bj * 128 + n * 16) = o; } }
    }
};

struct Args {
    const float *x, *meta, *ln_in_g, *ln_in_b, *rel_bias, *w_in, *b_gate, *kn_g, *kn_b, *w_pa, *w_pb, *w_o, *ln_g, *ln_b;
    float* out; unsigned char* ws;
};
struct Frame { LAS unsigned char* lds; int tid, lane, wave, vcu, G; };

__device__ __forceinline__ void block_local_sync() {
    asm volatile("s_waitcnt vmcnt(0) lgkmcnt(0)" ::: "memory"); __syncthreads();
    __builtin_amdgcn_fence(__ATOMIC_ACQUIRE, "agent"); asm volatile("s_waitcnt vmcnt(0)" ::: "memory"); __syncthreads();
}

__device__ __forceinline__ void transpose_item(const float* W, int ldw, int src_col0, int nvalid, f16* WT, int K, int dst_row0, int k0, LAS float* scr, int lane) {
    const int nn = lane & 31; const bool ok = nn < nvalid;
#pragma unroll 8
    for (int i = 0; i < 32; ++i) { const int kk = 2 * i + (lane >> 5); scr[kk * 33 + nn] = ok ? W[(size_t)(k0 + kk) * ldw + src_col0 + nn] : 0.f; }
    asm volatile("s_waitcnt lgkmcnt(0)" ::: "memory");
    const int c = lane & 7;
#pragma unroll
    for (int j = 0; j < 4; ++j) { const int n = (lane >> 3) + 8 * j; const LAS float* s = scr + (8 * c) * 33 + n;
        u32x4 o; o.x = pk_h2(s[0 * 33], s[1 * 33]); o.y = pk_h2(s[2 * 33], s[3 * 33]); o.z = pk_h2(s[4 * 33], s[5 * 33]); o.w = pk_h2(s[6 * 33], s[7 * 33]);
        *(u32x4*)(WT + (size_t)(dst_row0 + n) * K + k0 + 8 * c) = o; }
    asm volatile("s_waitcnt lgkmcnt(0)" ::: "memory");
}
__device__ __forceinline__ void ln_row(const float* xrow, const float* g, const float* b, int lane, f32x4 (&v)[4]) {
    float s = 0.f;
#pragma unroll
    for (int j = 0; j < 4; ++j) { v[j] = *(const f32x4*)(xrow + 4 * lane + 256 * j); s += (v[j][0] + v[j][1]) + (v[j][2] + v[j][3]); }
    const float mean = wave_sum(s) * (1.f / D); float s2 = 0.f;
#pragma unroll
    for (int j = 0; j < 4; ++j) { v[j] = v[j] - mean; s2 += (v[j][0] * v[j][0] + v[j][1] * v[j][1]) + (v[j][2] * v[j][2] + v[j][3] * v[j][3]); }
    const float rstd = 1.0f / sqrtf(wave_sum(s2) * (1.f / D) + LN_EPS);
#pragma unroll
    for (int j = 0; j < 4; ++j) { const f32x4 gg = *(const f32x4*)(g + 4 * lane + 256 * j), bb = *(const f32x4*)(b + 4 * lane + 256 * j); v[j] = v[j] * rstd * gg + bb; }
}

__device__ __forceinline__ Frame make_frame(LAS unsigned char* lds) {
    Frame F; F.lds = lds; F.tid = opaque_tid(); F.lane = F.tid & 63; F.wave = __builtin_amdgcn_readfirstlane(F.tid >> 6);
    F.G = gridDim.x; { const int bx = blockIdx.x; F.vcu = (F.G % 8 == 0) ? (bx % 8) * (F.G / 8) + bx / 8 : bx; }
    return F;
}

__device__ __forceinline__ void p0_prologue(LAS unsigned char* lds, const Args& a) {
    const Frame F = make_frame(lds);
    unsigned char* ws = opaque_ptr(a.ws);
    f16* W1T = (f16*)(ws + WS_W1T); f16* W2T = (f16*)(ws + WS_W2T); f16* WPA = (f16*)(ws + WS_WPA); f16* WPB = (f16*)(ws + WS_WPB); f16* WOT = (f16*)(ws + WS_WO);
    f16* H16 = (f16*)(ws + WS_H16);
    for (int it = F.vcu; it < 19; it += F.G) {
        LAS float* hm = (LAS float*)F.lds;
        LAS float* red = (LAS float*)(F.lds + 65536);
#pragma unroll
        for (int rr = 0; rr < 2; ++rr) { const int row = 2 * F.wave + rr; f32x4 v[4]; ln_row(a.meta + (size_t)row * D, a.ln_in_g, a.ln_in_b, F.lane, v);
#pragma unroll
            for (int j = 0; j < 4; ++j) *(LAS f32x4*)(hm + row * D + 4 * F.lane + 256 * j) = v[j]; }
        __syncthreads();
        int src, ld, dcol; f16* dst;
        if (it < 8) { src = 512 + 64 * it; dst = (f16*)(ws + WS_KA); ld = 512; dcol = 64 * it; }
        else if (it < 16) { src = 1024 + 64 * (it - 8); dst = (f16*)(ws + WS_VA); ld = 512; dcol = 64 * (it - 8); }
        else if (it == 16) { src = 2560; dst = (f16*)(ws + WS_KB); ld = 64; dcol = 0; }
        else if (it == 17) { src = 2624; dst = (f16*)(ws + WS_VB); ld = 64; dcol = 0; }
        else { src = 3712; dst = (f16*)(ws + WS_KI); ld = 64; dcol = 0; }
        float acc[16];
#pragma unroll
        for (int r = 0; r < 16; ++r) acc[r] = 0.f;
        const int kb = F.wave * 128;
#pragma unroll 4
        for (int k = 0; k < 128; ++k) { const float w = a.w_in[(size_t)(kb + k) * INC + src + F.lane];
#pragma unroll
            for (int r = 0; r < 16; ++r) acc[r] += hm[r * D + kb + k] * w; }
#pragma unroll
        for (int r = 0; r < 16; ++r) red[(F.wave * 16 + r) * 64 + F.lane] = acc[r];
        __syncthreads();
#pragma unroll
        for (int rr = 0; rr < 2; ++rr) { const int row = 2 * F.wave + rr; float v = 0.f;
#pragma unroll
            for (int w = 0; w < 8; ++w) v += red[(w * 16 + row) * 64 + F.lane];
            if (it == 18) { const float mean = wave_sum(v) * (1.f / 64.f); const float d = v - mean; const float rstd = 1.0f / sqrtf(wave_sum(d * d) * (1.f / 64.f) + LN_EPS); v = d * rstd * a.kn_g[F.lane] + a.kn_b[F.lane]; }
            const f16 hv = (f16)v;
            for (int bb = 0; bb < BATCH; ++bb) dst[((size_t)bb * TT + row) * ld + dcol + F.lane] = hv; }
        __syncthreads();
    }
    LAS float* scr = (LAS float*)(F.lds + F.wave * 16384);
    const int gw = F.vcu * 8 + F.wave, NGW = F.G * 8;
    constexpr int I1 = 88 * 16, I2 = 96 * 16, IPA = 32 * 8, IPB = 32 * 8, IO = 32 * 16, NITEMS = I1 + I2 + IPA + IPB + IO;
    for (int it = gw; it < NITEMS; it += NGW) {
        int r = it;
        if (r < I1) { const int nb = r % 88, kb = r / 88, n = 32 * nb; int src, nv = 32;
            if (n < 1536) src = n; else if (n < 2048) src = n + 512; else if (n < 2560) src = n + 1152;
            else { const int L = n - 2560, wc = (L >> 5) & 3, bj = L >> 7, cp = 32 * bj; if (wc == 0) src = 2560 + cp; else if (wc == 1) src = 2624 + cp; else if (wc == 2) src = 3712 + cp; else { src = 3776; nv = bj == 0 ? 8 : 0; } }
            transpose_item(a.w_in, INC, src, nv, W1T, D, n, 64 * kb, scr, F.lane); continue; }
        r -= I1;
        if (r < I2) { const int nb = r % 96, kb = r / 96, n = 32 * nb; int src;
            if (n < 512) src = 1536 + n; else if (n < 1024) src = 2688 + (n - 512); else if (n < 2048) src = 3784 + (n - 1024); else src = 4808 + (n - 2048);
            transpose_item(a.w_in, INC, src, 32, W2T, D, n, 64 * kb, scr, F.lane); continue; }
        r -= I2;
        if (r < IPA) { const int nb = r % 32, kb = r / 32; transpose_item(a.w_pa, D, 32 * nb, 32, WPA, 512, 32 * nb, 64 * kb, scr, F.lane); continue; }
        r -= IPA;
        if (r < IPB) { const int nb = r % 32, kb = r / 32; transpose_item(a.w_pb, D, 32 * nb, 32, WPB, 512, 32 * nb, 64 * kb, scr, F.lane); continue; }
        r -= IPB;
        { const int nb = r % 32, kb = r / 32; transpose_item(a.w_o, D, 32 * nb, 32, WOT, D, 32 * nb, 64 * kb, scr, F.lane); }
    }
    for (int m = gw; m < MQ; m += NGW) { f32x4 v[4]; ln_row(a.x + (size_t)m * D, a.ln_in_g, a.ln_in_b, F.lane, v);
#pragma unroll
        for (int j = 0; j < 4; ++j) { u32x2 o; o.x = pk_h2(v[j][0], v[j][1]); o.y = pk_h2(v[j][2], v[j][3]); *(u32x2*)(H16 + (size_t)m * D + 4 * F.lane + 256 * j) = o; } }
}

#define MFMA32(a, b, c) __builtin_amdgcn_mfma_f32_32x32x16_f16((a), (b), (c), 0, 0, 0)
#define MFMA16(a, b, c) __builtin_amdgcn_mfma_f32_16x16x32_f16((a), (b), (c), 0, 0, 0)
__device__ __forceinline__ h8 pack_frag(const f32x16& p, int s) {
    u32x4 w; w.x = pk_h2(p[8 * s + 0], p[8 * s + 1]); w.y = pk_h2(p[8 * s + 2], p[8 * s + 3]); w.z = pk_h2(p[8 * s + 4], p[8 * s + 5]); w.w = pk_h2(p[8 * s + 6], p[8 * s + 7]);
    return __builtin_bit_cast(h8, w);
}
__device__ __forceinline__ v4i16_t tr_read(LAS unsigned char* p) { return __builtin_amdgcn_ds_read_tr16_b64_v4i16((LAS v4i16_t*)p); }
__device__ __forceinline__ void v_tile_store(LAS unsigned char* img, const u32x4 (&vr)[4], int lane) {
#pragma unroll
    for (int i = 0; i < 4; ++i) { const int c = lane + 64 * i, row = c >> 3, cc = c & 7;
        *(LAS u32x4*)(img + (cc >> 2) * 2048 + (row >> 4) * 1024 + (row & 15) * 64 + (cc & 3) * 16) = vr[i]; }
}
__device__ __forceinline__ void pv_tile(f32x16& o0, f32x16& o1, LAS unsigned char* img, const h8 pf0, const h8 pf1, int lane) {
    LAS unsigned char* vb = img + ((lane >> 4) & 1) * 32 + (lane & 3) * 8 + (4 * (lane >> 5) + ((lane & 15) >> 2)) * 64;
#pragma unroll
    for (int d0 = 0; d0 < 2; ++d0)
#pragma unroll
        for (int ks = 0; ks < 2; ++ks) {
            const v4i16_t lo = tr_read(vb + d0 * 2048 + ks * 1024), hi = tr_read(vb + d0 * 2048 + ks * 1024 + 512);
            const h8 vf = __builtin_bit_cast(h8, __builtin_shufflevector(lo, hi, 0, 1, 2, 3, 4, 5, 6, 7));
            if (d0 == 0) o0 = MFMA32(vf, ks == 0 ? pf0 : pf1, o0); else o1 = MFMA32(vf, ks == 0 ? pf0 : pf1, o1);
        }
}
__device__ __forceinline__ void store_ot(f16* orow  , const f32x16& o0, const f32x16& o1, int hi, float sc) {
#pragma unroll
    for (int g = 0; g < 4; ++g) {
        u32x2 w0, w1; w0.x = pk_h2(o0[4 * g] * sc, o0[4 * g + 1] * sc); w0.y = pk_h2(o0[4 * g + 2] * sc, o0[4 * g + 3] * sc);
        w1.x = pk_h2(o1[4 * g] * sc, o1[4 * g + 1] * sc); w1.y = pk_h2(o1[4 * g + 2] * sc, o1[4 * g + 3] * sc);
        *(u32x2*)(orow + 8 * g + 4 * hi) = w0; *(u32x2*)(orow + 32 + 8 * g + 4 * hi) = w1; }
}

__device__ __forceinline__ void sb_task(const Frame& F, int bh, int qt, const f16* QA, const f16* KA, const f16* VA, f16* OA) {
    const int lane = F.lane, r32 = lane & 31, hi = lane >> 5;
    const int b = bh >> 3, h = bh & 7;
    const int t = NMETA + 32 * qt + r32;
    const size_t mq = (size_t)b * SEQ + 32 * qt + r32;
    h8 qf[4];
#pragma unroll
    for (int s = 0; s < 4; ++s) qf[s] = *(const h8*)(QA + mq * 512 + h * 64 + 16 * s + 8 * hi);
    const f16* Kb = KA + (size_t)b * TT * 512 + h * 64; const f16* Vb = VA + (size_t)b * TT * 512 + h * 64;
    LAS unsigned char* img = F.lds + F.wave * 4096;
    f32x16 o0, o1;
#pragma unroll
    for (int r = 0; r < 16; ++r) { o0[r] = 0.f; o1[r] = 0.f; }
    float C = 1.0f;
    for (int kt = qt + 1; kt >= 0; --kt) {
        const int k0 = 32 * kt;
        const int krow = min(k0 + r32, TT - 1);
        h8 kf[4];
#pragma unroll
        for (int s = 0; s < 4; ++s) kf[s] = *(const h8*)(Kb + (size_t)krow * 512 + 16 * s + 8 * hi);
        u32x4 vr[4];
#pragma unroll
        for (int i = 0; i < 4; ++i) { const int c = lane + 64 * i, row = c >> 3, cc = c & 7; const int vrow = min(k0 + row, TT - 1); vr[i] = *(const u32x4*)(Vb + (size_t)vrow * 512 + cc * 8); }
        f32x16 x;
#pragma unroll
        for (int r = 0; r < 16; ++r) x[r] = 0.f;
#pragma unroll
        for (int s = 0; s < 4; ++s) x = MFMA32(kf[s], qf[s], x);
        float omb[16], beta[16];
#pragma unroll
        for (int r = 0; r < 16; ++r) { const float e = __builtin_amdgcn_exp2f(x[r]); omb[r] = __builtin_amdgcn_rcpf(1.0f + e); }
        if (kt >= qt) {
#pragma unroll
            for (int r = 0; r < 16; ++r) { const int key = k0 + crow(r, hi); if (key >= t) omb[r] = 1.0f; }
        }
#pragma unroll
        for (int r = 0; r < 16; ++r) beta[r] = 1.0f - omb[r];
        float sfx[16], G0[4], G1[4];
#pragma unroll
        for (int g = 0; g < 4; ++g) {
            sfx[4 * g + 3] = 1.0f; sfx[4 * g + 2] = omb[4 * g + 3]; sfx[4 * g + 1] = sfx[4 * g + 2] * omb[4 * g + 2]; sfx[4 * g] = sfx[4 * g + 1] * omb[4 * g + 1];
            const float Gp = sfx[4 * g] * omb[4 * g];
            const auto rr = __builtin_amdgcn_permlane32_swap(__float_as_uint(Gp), __float_as_uint(Gp), false, false);
            G0[g] = __uint_as_float(rr[0]); G1[g] = __uint_as_float(rr[1]);
        }
        float run = C; float cgp[4];
#pragma unroll
        for (int g = 3; g >= 0; --g) { const float c1 = run; const float c0 = run * G1[g]; run = c0 * G0[g]; cgp[g] = hi ? c1 : c0; }
        C = run;
        f32x16 a;
#pragma unroll
        for (int r = 0; r < 16; ++r) a[r] = beta[r] * sfx[r] * cgp[r >> 2];
        const h8 pf0 = pack_frag(a, 0), pf1 = pack_frag(a, 1);
        v_tile_store(img, vr, lane);
        asm volatile("s_waitcnt lgkmcnt(0)" ::: "memory");
        pv_tile(o0, o1, img, pf0, pf1, lane);
        asm volatile("s_waitcnt lgkmcnt(0)" ::: "memory");
        if (__ballot(C != 0.0f) == 0ull) break;
    }
    store_ot(OA + mq * 512 + h * 64, o0, o1, hi, 1.0f);
}

__device__ __forceinline__ unsigned fkey(float f) { const unsigned u = __float_as_uint(f); return u ^ ((unsigned)((int)u >> 31) | 0x80000000u); }

__device__ __forceinline__ void dsa_subtask(const Frame& F, int b, int i, const f16* QB, const f16* QI, const f16* KB, const f16* VB, const f16* KI, const float* WI, f16* OB) {
    const int lane = F.lane, w = F.wave;
    LAS float* S = (LAS float*)F.lds;
    LAS unsigned* maskbuf = (LAS unsigned*)(F.lds + MASK_OFF);
    const LAS float* btab = (const LAS float*)(F.lds + BTAB_OFF);
    const int nk = 16 * i + 32;
    {
        const int q16 = lane & 15, kg = lane >> 4;
        const size_t mq = (size_t)b * SEQ + 16 * i + q16; const int tq = NMETA + 16 * i + q16;
        h8 qif[8][2];
#pragma unroll
        for (int h = 0; h < 8; ++h)
#pragma unroll
            for (int s = 0; s < 2; ++s) qif[h][s] = *(const h8*)(QI + mq * 512 + h * 64 + 32 * s + 8 * kg);
        const f32x4 w0 = *(const f32x4*)(WI + mq * 8), w1 = *(const f32x4*)(WI + mq * 8 + 4);
        const float wv[8] = {w0[0], w0[1], w0[2], w0[3], w1[0], w1[1], w1[2], w1[3]};
        const int nt16 = i + 2;
        for (int kt = w; kt < nt16; kt += 8) {
            const int k0 = 16 * kt;
            const f16* kp = KI + ((size_t)b * TT + k0 + q16) * 64 + 8 * kg;
            const h8 kf0 = *(const h8*)(kp), kf1 = *(const h8*)(kp + 32);
            f32x4 sc = {0.f, 0.f, 0.f, 0.f};
#pragma unroll
            for (int h = 0; h < 8; ++h) { f32x4 acc = {0.f, 0.f, 0.f, 0.f}; acc = MFMA16(kf0, qif[h][0], acc); acc = MFMA16(kf1, qif[h][1], acc);
#pragma unroll
                for (int r = 0; r < 4; ++r) sc[r] += wv[h] * fmaxf(acc[r], 0.f); }
#pragma unroll
            for (int r = 0; r < 4; ++r) { const int key = k0 + 4 * kg + r; float v = sc[r] + 0.0f; if (key > tq) v = -INFINITY; sc[r] = v; }
            *(LAS f32x4*)(S + q16 * SPITCH + k0 + 4 * kg) = sc;
        }
    }
    __syncthreads();
#pragma unroll 1
    for (int rr = 0; rr < 2; ++rr) {
        const int q = w + 8 * rr; const int tq = NMETA + 16 * i + q;
        const LAS float* Sr = S + q * SPITCH;
        unsigned uk[33];
#pragma unroll
        for (int j = 0; j < 33; ++j) { const int idx = lane + 64 * j; uk[j] = idx < nk ? fkey(Sr[idx]) : 0u; }
        const bool all = (tq + 1) <= 256;
        unsigned tau = 0u; int cutoff = 0x7fffffff;
        if (!all) {
            unsigned prefix = 0u;
            for (int bit = 31; bit >= 0; --bit) {
                const unsigned cand = prefix | (1u << bit); int cnt = 0;
#pragma unroll
                for (int j = 0; j < 33; ++j) cnt += __popcll(__ballot(uk[j] >= cand));
                if (cnt >= 256) prefix = cand;
            }
            tau = prefix;
            int cgt = 0, ceq = 0;
#pragma unroll
            for (int j = 0; j < 33; ++j) { cgt += __popcll(__ballot(uk[j] > tau)); ceq += __popcll(__ballot(uk[j] == tau)); }
            const int need = 256 - cgt;
            if (ceq > need) {
                int lo = 0;
                for (int bit = 11; bit >= 0; --bit) { const int cand = lo | (1 << bit); int cnt = 0;
#pragma unroll
                    for (int j = 0; j < 33; ++j) cnt += __popcll(__ballot(uk[j] == tau && (lane + 64 * j) < cand));
                    if (cnt < need) lo = cand; }
                cutoff = lo;
            }
        }
#pragma unroll
        for (int j = 0; j < 33; ++j) { const int idx = lane + 64 * j;
            const bool sel = all ? (idx <= tq) : (uk[j] > tau || (uk[j] == tau && idx <= cutoff));
            const unsigned long long mk = __ballot(sel);
            if (lane == 0) { maskbuf[q * MASK_W + 2 * j] = (unsigned)mk; maskbuf[q * MASK_W + 2 * j + 1] = (unsigned)(mk >> 32); } }
    }
    __syncthreads();
    {
        const int hp = w & 3, kh = w >> 2, c = lane & 31, hi = lane >> 5, q = c & 15, head = 2 * hp + (c >> 4);
        const size_t mq = (size_t)b * SEQ + 16 * i + q; const int tq = NMETA + 16 * i + q;
        h8 qf[4];
#pragma unroll
        for (int s = 0; s < 4; ++s) qf[s] = *(const h8*)(QB + mq * 512 + head * 64 + 16 * s + 8 * hi);
        LAS unsigned char* img = F.lds + w * 4096;
        float mrun = -3.0e38f, lrun = 0.f;
        f32x16 o0, o1;
#pragma unroll
        for (int r = 0; r < 16; ++r) { o0[r] = 0.f; o1[r] = 0.f; }
        const int NT32 = (nk + 31) >> 5;
        for (int T = kh; T < NT32; T += 2) {
            const int k0 = 32 * T;
            const int krow = min(k0 + c, TT - 1);
            h8 kf[4];
#pragma unroll
            for (int s = 0; s < 4; ++s) kf[s] = *(const h8*)(KB + ((size_t)b * TT + krow) * 64 + 16 * s + 8 * hi);
            u32x4 vr[4];
#pragma unroll
            for (int i2 = 0; i2 < 4; ++i2) { const int ci = lane + 64 * i2, row = ci >> 3, cc = ci & 7; const int vrow = min(k0 + row, TT - 1); vr[i2] = *(const u32x4*)(VB + ((size_t)b * TT + vrow) * 64 + cc * 8); }
            f32x16 x;
#pragma unroll
            for (int r = 0; r < 16; ++r) x[r] = 0.f;
#pragma unroll
            for (int s = 0; s < 4; ++s) x = MFMA32(kf[s], qf[s], x);
            const unsigned mw = maskbuf[q * MASK_W + T] >> (4 * hi);
            float tmax = -3.0e38f;
#pragma unroll
            for (int r = 0; r < 16; ++r) { const int key = k0 + crow(r, hi); int dist = tq - key; dist = dist < 0 ? 0 : (dist > 127 ? 127 : dist);
                x[r] += btab[dist * 8 + head];
                const bool bit = (mw >> ((r & 3) + 8 * (r >> 2))) & 1u;
                tmax = fmaxf(tmax, bit ? x[r] : -3.0e38f); }
            { const auto rr = __builtin_amdgcn_permlane32_swap(__float_as_uint(tmax), __float_as_uint(tmax), false, false); tmax = fmaxf(__uint_as_float(rr[0]), __uint_as_float(rr[1])); }
            const float mnew = fmaxf(mrun, tmax); const float scale = __builtin_amdgcn_exp2f(mrun - mnew); mrun = mnew;
            f32x16 p; float ls = 0.f;
#pragma unroll
            for (int r = 0; r < 16; ++r) { const bool bit = (mw >> ((r & 3) + 8 * (r >> 2))) & 1u; const float e = __builtin_amdgcn_exp2f(x[r] - mnew); p[r] = bit ? e : 0.f; ls += p[r]; }
            lrun = lrun * scale + ls;
#pragma unroll
            for (int r = 0; r < 16; ++r) { o0[r] *= scale; o1[r] *= scale; }
            const h8 pf0 = pack_frag(p, 0), pf1 = pack_frag(p, 1);
            v_tile_store(img, vr, lane);
            asm volatile("s_waitcnt lgkmcnt(0)" ::: "memory");
            pv_tile(o0, o1, img, pf0, pf1, lane);
            asm volatile("s_waitcnt lgkmcnt(0)" ::: "memory");
        }
        { const auto rr = __builtin_amdgcn_permlane32_swap(__float_as_uint(lrun), __float_as_uint(lrun), false, false); lrun = __uint_as_float(rr[0]) + __uint_as_float(rr[1]); }
        __syncthreads();
        LAS float* mb = (LAS float*)(F.lds + MERGE_OFF) + (hp * 64 + lane) * 34;
        if (kh == 1) { mb[0] = mrun; mb[1] = lrun;
#pragma unroll
            for (int r = 0; r < 16; ++r) { mb[2 + r] = o0[r]; mb[18 + r] = o1[r]; } }
        __syncthreads();
        if (kh == 0) {
            const float m1 = mb[0], l1 = mb[1];
            const float M = fmaxf(mrun, m1); const float s0 = __builtin_amdgcn_exp2f(mrun - M), s1 = __builtin_amdgcn_exp2f(m1 - M);
            const float L = lrun * s0 + l1 * s1; const float inv = 1.0f / L;
#pragma unroll
            for (int r = 0; r < 16; ++r) { o0[r] = o0[r] * s0 + mb[2 + r] * s1; o1[r] = o1[r] * s0 + mb[18 + r] * s1; }
            store_ot(OB + mq * 512 + head * 64, o0, o1, hi, inv);
        }
        __syncthreads();
    }
}

__device__ __forceinline__ void phaseB(LAS unsigned char* lds, const Args& a) {
    const Frame F = make_frame(lds);
    unsigned char* ws = opaque_ptr(a.ws);
    const f16* QA = (const f16*)(ws + WS_QA); const f16* QB = (const f16*)(ws + WS_QB); const f16* QI = (const f16*)(ws + WS_QI);
    const f16* KA = (const f16*)(ws + WS_KA); const f16* VA = (const f16*)(ws + WS_VA); const f16* KB = (const f16*)(ws + WS_KB);
    const f16* VB = (const f16*)(ws + WS_VB); const f16* KI = (const f16*)(ws + WS_KI); const float* WI = (const float*)(ws + WS_WI);
    f16* OA = (f16*)(ws + WS_OA); f16* OB = (f16*)(ws + WS_OB);
    { LAS float* bt = (LAS float*)(F.lds + BTAB_OFF); for (int e = F.tid; e < 1024; e += 512) bt[e] = a.rel_bias[(int)BUCKET[e >> 3] * 8 + (e & 7)] * LOG2E; }
    __syncthreads();
    for (int T = F.vcu; T < BATCH * 64; T += F.G) {
        const int b = T >> 6, p = T & 63;
        dsa_subtask(F, b, p, QB, QI, KB, VB, KI, WI, OB);
        dsa_subtask(F, b, 127 - p, QB, QI, KB, VB, KI, WI, OB);
    }
    __syncthreads();
    for (int bh = F.vcu; bh < BATCH * 8; bh += F.G)
        for (int qb = 0; qb < 8; ++qb) sb_task(F, bh, qb * 8 + F.wave, QA, KA, VA, OA);
    __syncthreads();
}

__global__ void __launch_bounds__(512, 2) fwd_megakernel(Args a) {
    extern __shared__ __attribute__((aligned(16))) unsigned char lds_raw[];
    cg::grid_group grid = cg::this_grid();
    LAS unsigned char* lds = (LAS unsigned char*)lds_raw;

    p0_prologue(lds, a);
    grid.sync();

    {
        unsigned char* ws = opaque_ptr(a.ws);
        pg8::Gemm g{(const f16*)(ws + WS_H16), (const f16*)(ws + WS_W1T), MQ, N1, D}; pg8::StaticOrder S; S.init(MQ, N1, (int)gridDim.x, (int)blockIdx.x);
        EpiA E{(f16*)(ws + WS_QA), (f16*)(ws + WS_QB), (f16*)(ws + WS_QI), (f16*)(ws + WS_KA), (f16*)(ws + WS_VA), (f16*)(ws + WS_KB), (f16*)(ws + WS_VB), (f16*)(ws + WS_KI), (float*)(ws + WS_WI), a.kn_g, a.kn_b};
        pg8::gemm_phase<EpiA, pg8::StaticOrder, true, true>(lds, g, S, E);
    }
    grid.sync();

    phaseB(lds, a);
    grid.sync();

    {
        const int G = (int)gridDim.x; const int vcu = (G % 8 == 0) ? ((int)blockIdx.x % 8) * (G / 8) + (int)blockIdx.x / 8 : (int)blockIdx.x;
        { unsigned char* ws = opaque_ptr(a.ws);
          pg8::Gemm g{(const f16*)(ws + WS_H16), (const f16*)(ws + WS_W2T), MQ, N2, D}; pg8::PanelOrder S; S.init(MQ, N2, G, vcu);
          EpiZ E{(const f16*)(ws + WS_OA), (const f16*)(ws + WS_OB), (f16*)(ws + WS_YA), (f16*)(ws + WS_YB), (f16*)(ws + WS_G), a.b_gate};
          pg8::gemm_phase<EpiZ, pg8::PanelOrder, true, true>(lds, g, S, E); }
        block_local_sync();
        { unsigned char* ws = opaque_ptr(a.ws);
          pg8::Gemm g{(const f16*)(ws + WS_YA), (const f16*)(ws + WS_WPA), MQ, D, 512}; pg8::PanelOrder S; S.init(MQ, D, G, vcu);
          EpiU<0> E{(const f16*)(ws + WS_G), (f16*)(ws + WS_T), (f16*)(ws + WS_MG)};
          pg8::gemm_phase<EpiU<0>, pg8::PanelOrder, true, true>(lds, g, S, E); }
        block_local_sync();
        { unsigned char* ws = opaque_ptr(a.ws);
          pg8::Gemm g{(const f16*)(ws + WS_YB), (const f16*)(ws + WS_WPB), MQ, D, 512}; pg8::PanelOrder S; S.init(MQ, D, G, vcu);
          EpiU<1> E{(const f16*)(ws + WS_G), (f16*)(ws + WS_T), (f16*)(ws + WS_MG)};
          pg8::gemm_phase<EpiU<1>, pg8::PanelOrder, true, true>(lds, g, S, E); }
        block_local_sync();
        { unsigned char* ws = opaque_ptr(a.ws);
          pg8::Gemm g{(const f16*)(ws + WS_MG), (const f16*)(ws + WS_WO), MQ, D, D}; pg8::PanelOrder S; S.init(MQ, D, G, vcu);
          EpiR E{(const f16*)(ws + WS_H16), a.out};
          pg8::gemm_phase<EpiR, pg8::PanelOrder, true, true>(lds, g, S, E); }
        block_local_sync();
        { const int tid = opaque_tid(), lane = tid & 63, wave = tid >> 6;
          for (int p = vcu; p < MQ / 256; p += G)
            for (int r = wave; r < 256; r += 8) { float* row = a.out + ((size_t)p * 256 + r) * D; f32x4 v[4]; ln_row(row, a.ln_g, a.ln_b, lane, v);
#pragma unroll
                for (int j = 0; j < 4; ++j) *(f32x4*)(row + 4 * lane + 256 * j) = v[j]; } }
    }
}

extern "C" void kernel_launch(void* const* d_in, const int* in_sizes, int n_in, void* d_out, int out_size, void* d_ws, size_t ws_size, hipStream_t stream) {
    static int grid = 0;
    if (grid == 0) {
        if (n_in != 14 || in_sizes[0] != MQ * D || out_size != MQ * D || ws_size < WS_END) { fprintf(stderr, "kernel_launch: unexpected shapes (n_in %d, in0 %d, out %d, ws %zu)\n", n_in, n_in > 0 ? in_sizes[0] : -1, out_size, ws_size); grid = -1; return; }
        int dev = 0, cus = 0, per_cu = 0;
        hipGetDevice(&dev); hipDeviceGetAttribute(&cus, hipDeviceAttributeMultiprocessorCount, dev);
        if (hipFuncSetAttribute((const void*)fwd_megakernel, hipFuncAttributeMaxDynamicSharedMemorySize, LDS_BYTES) != hipSuccess) { fprintf(stderr, "kernel_launch: hipFuncSetAttribute failed\n"); grid = -1; return; }
        if (hipOccupancyMaxActiveBlocksPerMultiprocessor(&per_cu, (const void*)fwd_megakernel, 512, LDS_BYTES) != hipSuccess || per_cu < 1) { fprintf(stderr, "kernel_launch: occupancy query says %d\n", per_cu); per_cu = 1; }
        (void)hipGetLastError();
        grid = cus * (per_cu > 1 ? 1 : per_cu);
    }
    if (grid < 0) return;
    Args a{};
    a.x = (const float*)d_in[0]; a.meta = (const float*)d_in[1]; a.ln_in_g = (const float*)d_in[2]; a.ln_in_b = (const float*)d_in[3]; a.rel_bias = (const float*)d_in[4];
    a.w_in = (const float*)d_in[5]; a.b_gate = (const float*)d_in[6]; a.kn_g = (const float*)d_in[7]; a.kn_b = (const float*)d_in[8]; a.w_pa = (const float*)d_in[9];
    a.w_pb = (const float*)d_in[10]; a.w_o = (const float*)d_in[11]; a.ln_g = (const float*)d_in[12]; a.ln_b = (const float*)d_in[13];
    a.out = (float*)d_out; a.ws = (unsigned char*)d_ws;
    void* args[] = {&a};
    hipError_t e = hipLaunchCooperativeKernel((const void*)fwd_megakernel, dim3(grid), dim3(512), args, LDS_BYTES, stream);
    if (e != hipSuccess) fprintf(stderr, "kernel_launch: cooperative launch failed: %s (grid %d)\n", hipGetErrorString(e), grid);
}
```
